# Optimizing an MI355X kernel written in HIP

```python
import jax, jax.numpy as jnp
from jax import lax
import numpy as np

D_MODEL = 1024
BATCH = 4
SEQ = 8192
DEPTH = 2

CHUNK = 64
D_MIX = D_MODEL
D_LRU = D_MIX // 2
D_ATTN = D_MIX - D_LRU
HEAD_DIM = 64
N_ATTN_HEADS = D_ATTN // HEAD_DIM
LRU_BLOCKS = 8
LRU_BLOCK_W = D_LRU // LRU_BLOCKS
CONV_W = 4
LRU_C = 8.0
Q_BLOCK = 128
N_IN = 2 * D_LRU + 4 * D_ATTN + N_ATTN_HEADS
DEEPNORM_ALPHA = (2.0 * DEPTH) ** 0.25
DEEPNORM_BETA = (8.0 * DEPTH) ** -0.25
LN_EPS = 1e-5
NEG_INF = -1e30

kernel_name = "hymba_rglru_fox_adaln_deepnorm"


def _layer_norm(x):
    x32 = x.astype(jnp.float32)
    mu = jnp.mean(x32, axis=-1, keepdims=True)
    var = jnp.mean(jnp.square(x32 - mu), axis=-1, keepdims=True)
    return (x32 - mu) * lax.rsqrt(var + LN_EPS)


def _rms_norm(y, g):
    y32 = y.astype(jnp.float32)
    return y32 * lax.rsqrt(jnp.mean(jnp.square(y32), axis=-1, keepdims=True) + LN_EPS) * g.astype(jnp.float32)


def _causal_depthwise_conv(x, w, b):
    K = w.shape[0]
    S = x.shape[1]
    xp = jnp.pad(x, ((0, 0), (K - 1, 0), (0, 0)))
    out = b
    for k in range(K):
        out = out + xp[:, k:k + S, :] * w[k]
    return out


def _rg_lru(x, w_a, b_a, w_x, b_x, lam):
    B, S, C = x.shape
    xb = x.reshape(B, S, LRU_BLOCKS, LRU_BLOCK_W)
    r = jax.nn.sigmoid((jnp.einsum('bsnd,nde->bsne', xb, w_a).reshape(B, S, C) + b_a).astype(jnp.float32))
    i = jax.nn.sigmoid((jnp.einsum('bsnd,nde->bsne', xb, w_x).reshape(B, S, C) + b_x).astype(jnp.float32))
    log_a = -LRU_C * r * jax.nn.softplus(-lam.astype(jnp.float32))
    a = jnp.exp(log_a)
    mult = jnp.sqrt(-jnp.expm1(2.0 * log_a))
    u = mult * (i * x.astype(jnp.float32))

    def combine(left, right):
        a1, b1 = left
        a2, b2 = right
        return a2 * a1, a2 * b1 + b2

    _, h = lax.associative_scan(combine, (a, u), axis=1)
    return h


def _forgetting_attention(q, k, v, log_f):
    B, S, _ = q.shape
    H, dh = N_ATTN_HEADS, HEAD_DIM
    q = q.reshape(B, S, H, dh).transpose(0, 2, 1, 3)
    k = k.reshape(B, S, H, dh).transpose(0, 2, 1, 3)
    v = v.reshape(B, S, H, dh).transpose(0, 2, 1, 3)
    d_cum = jnp.cumsum(log_f.astype(jnp.float32), axis=1).transpose(0, 2, 1)
    scale = dh ** -0.5
    kpos = jnp.arange(S)
    n_blocks = S // Q_BLOCK

    def block(bi):
        qs = bi * Q_BLOCK
        qb = lax.dynamic_slice_in_dim(q, qs, Q_BLOCK, axis=2)
        dq = lax.dynamic_slice_in_dim(d_cum, qs, Q_BLOCK, axis=2)
        s = jnp.einsum('bhqd,bhkd->bhqk', qb, k).astype(jnp.float32) * scale
        s = s + (dq[..., :, None] - d_cum[:, :, None, :])
        qpos = qs + jnp.arange(Q_BLOCK)
        mask = kpos[None, :] <= qpos[:, None]
        s = jnp.where(mask, s, NEG_INF)
        p = jax.nn.softmax(s, axis=-1)
        return jnp.einsum('bhqk,bhkd->bhqd', p.astype(v.dtype), v)

    out = lax.map(block, jnp.arange(n_blocks))
    return out.transpose(1, 0, 3, 2, 4).reshape(B, S, H * dh)


def setup_inputs(seed: int = 0) -> dict:
    key = jax.random.key(seed)
    ks = jax.random.split(key, 18)
    f32 = jnp.float32
    x = jax.random.normal(ks[0], (BATCH, SEQ, D_MODEL), f32)
    c = jax.random.normal(ks[1], (BATCH, D_MODEL), f32)
    w_ada = jax.random.normal(ks[2], (DEPTH, D_MODEL, 3 * D_MODEL), f32) * (0.5 * D_MODEL ** -0.5)
    b_ada = 0.01 * jax.random.normal(ks[3], (DEPTH, 3 * D_MODEL), f32)
    w_in = jax.random.normal(ks[4], (DEPTH, D_MODEL, N_IN), f32) * D_MODEL ** -0.5
    b_fgate = jax.random.uniform(ks[5], (DEPTH, N_ATTN_HEADS), f32, minval=1.0, maxval=5.0)
    conv_w = jax.random.normal(ks[6], (DEPTH, CONV_W, D_LRU), f32) * CONV_W ** -0.5
    conv_b = 0.01 * jax.random.normal(ks[7], (DEPTH, D_LRU), f32)
    w_gate_a = jax.random.normal(ks[8], (DEPTH, LRU_BLOCKS, LRU_BLOCK_W, LRU_BLOCK_W), f32) * LRU_BLOCK_W ** -0.5
    b_gate_a = 0.01 * jax.random.normal(ks[9], (DEPTH, D_LRU), f32)
    w_gate_x = jax.random.normal(ks[10], (DEPTH, LRU_BLOCKS, LRU_BLOCK_W, LRU_BLOCK_W), f32) * LRU_BLOCK_W ** -0.5
    b_gate_x = 0.01 * jax.random.normal(ks[11], (DEPTH, D_LRU), f32)
    u = jax.random.uniform(ks[12], (DEPTH, D_LRU), f32, minval=0.9, maxval=0.999)
    a0 = u ** (1.0 / LRU_C)
    lru_lambda = jnp.log(a0) - jnp.log1p(-a0)
    norm_lru = 1.0 + 0.01 * jax.random.normal(ks[13], (DEPTH, D_LRU), f32)
    norm_attn = 1.0 + 0.01 * jax.random.normal(ks[14], (DEPTH, D_ATTN), f32)
    w_out = jax.random.normal(ks[15], (DEPTH, D_MIX, D_MODEL), f32) * (D_MIX ** -0.5 * DEEPNORM_BETA)
    ln_gain = 1.0 + 0.01 * jax.random.normal(ks[16], (DEPTH, D_MODEL), f32)
    ln_bias = 0.01 * jax.random.normal(ks[17], (DEPTH, D_MODEL), f32)
    return {"x": x, "c": c, "w_ada": w_ada, "b_ada": b_ada, "w_in": w_in, "b_fgate": b_fgate,
            "conv_w": conv_w, "conv_b": conv_b, "w_gate_a": w_gate_a, "b_gate_a": b_gate_a,
            "w_gate_x": w_gate_x, "b_gate_x": b_gate_x, "lru_lambda": lru_lambda,
            "norm_lru": norm_lru, "norm_attn": norm_attn, "w_out": w_out,
            "ln_gain": ln_gain, "ln_bias": ln_bias}


def reference(x, c, w_ada, b_ada, w_in, b_fgate, conv_w, conv_b, w_gate_a, b_gate_a,
              w_gate_x, b_gate_x, lru_lambda, norm_lru, norm_attn, w_out, ln_gain, ln_bias):
    dtype = x.dtype
    split_idx = [D_LRU, 2 * D_LRU, 2 * D_LRU + D_ATTN, 2 * D_LRU + 2 * D_ATTN,
                 2 * D_LRU + 3 * D_ATTN, 2 * D_LRU + 4 * D_ATTN]
    c_act = jax.nn.silu(c)
    for l in range(DEPTH):
        mod = c_act @ w_ada[l] + b_ada[l]
        shift, scale, gate = jnp.split(mod, 3, axis=-1)
        h = (_layer_norm(x) * (1.0 + scale[:, None, :].astype(jnp.float32))
             + shift[:, None, :].astype(jnp.float32)).astype(dtype)
        proj = h @ w_in[l]
        xr, zr, q, k, v, za, fl = jnp.split(proj, split_idx, axis=-1)
        xc = _causal_depthwise_conv(xr, conv_w[l], conv_b[l])
        y_r = _rg_lru(xc, w_gate_a[l], b_gate_a[l], w_gate_x[l], b_gate_x[l], lru_lambda[l])
        y_r = (_rms_norm(y_r, norm_lru[l]) * jax.nn.silu(zr.astype(jnp.float32))).astype(dtype)
        log_f = jax.nn.log_sigmoid((fl + b_fgate[l]).astype(jnp.float32))
        y_a = _forgetting_attention(q, k, v, log_f)
        y_a = (_rms_norm(y_a, norm_attn[l]) * jax.nn.silu(za.astype(jnp.float32))).astype(dtype)
        y = jnp.concatenate([y_r, y_a], axis=-1) @ w_out[l]
        res = DEEPNORM_ALPHA * x.astype(jnp.float32) + gate[:, None, :].astype(jnp.float32) * y.astype(jnp.float32)
        x = (_layer_norm(res) * ln_gain[l].astype(jnp.float32) + ln_bias[l].astype(jnp.float32)).astype(dtype)
    return x
```

```cpp
#include <hip/hip_runtime.h>
#include <cstdio>
#include <cstdint>
#include <cmath>
namespace pg8 {
#define PG8_LAS __attribute__((address_space(3)))
typedef unsigned short bf16_t;
typedef short bf16x8 __attribute__((ext_vector_type(8)));
typedef float f32x4 __attribute__((ext_vector_type(4)));
typedef unsigned u32x4 __attribute__((ext_vector_type(4)));
constexpr int BM = 256, BK = 64, HALF = 128, HTB = HALF * BK * 2  , STAGE_BYTES = 8 * HTB, NXCD = 8, WGM = 8;

__host__ __device__ __forceinline__ int lds_byte(int r, int c) { const int st = (r >> 4) * 2 + (c >> 5), rr = r & 15, cc = c & 31, ob = rr * 64 + cc * 2; return st * 1024 + (ob ^ (((ob >> 9) & 1) << 5)); }
__host__ __device__ __forceinline__ void stage_rc(int b, int& R, int& C) { const int st = b / 1024, sb = b % 1024, swz = sb ^ (((sb >> 9) & 1) << 5); R = (st >> 1) * 16 + swz / 64; C = (st & 1) * 32 + (swz % 64) / 2; }
__host__ __device__ __forceinline__ int perm32(int rho) { const int n = rho >> 4, i = rho & 15; return 8 * (i >> 2) + 4 * n + (i & 3); }

struct Unit { int pm, pn; };
struct Gemm { const bf16_t* A; const bf16_t* Bt; int M, N, K; };

struct StaticOrder {
    int nM, nN, nwg, G, c;
    __host__ __device__ void init(int M, int N, int G_, int c_) { nM = M / BM; nN = N / BM; nwg = nM * nN; G = G_; c = c_; }
    __host__ __device__ bool next(int i, Unit& u) const {
        const long L = (long)i * G + c; if (L >= nwg) return false;
        int wgid = (int)L; { const int q = nwg / NXCD, r = nwg % NXCD, xcd = wgid % NXCD, off = wgid / NXCD; wgid = (xcd < r ? xcd * (q + 1) : r * (q + 1) + (xcd - r) * q) + off; }
        const int nig = WGM * nN, gid = wgid / nig, fm = gid * WGM, gsz = (nM - fm) < WGM ? (nM - fm) : WGM;
        u.pm = fm + ((wgid % nig) % gsz); u.pn = (wgid % nig) / gsz; return true;
    }
    __device__ __forceinline__ void a_ready(const Unit&) const {}
    __device__ __forceinline__ void done(const Unit&) const {}
};

__device__ __forceinline__ unsigned cvt_pk_bf16(float lo, float hi) { unsigned r; asm volatile("v_cvt_pk_bf16_f32 %0, %1, %2" : "=v"(r) : "v"(lo), "v"(hi)); return r; }
typedef float f32x2 __attribute__((ext_vector_type(2)));
__device__ __forceinline__ f32x2 gelu_pk(f32x2 v) {
    const f32x2 av = __builtin_elementwise_abs(v), d = av * 0.2316418882f + 1.0f;
    f32x2 t; t.x = __builtin_amdgcn_rcpf(d.x); t.y = __builtin_amdgcn_rcpf(d.y);
    f32x2 q = t * 0.5307027145f + (-0.7265760135f); q = q * t + 0.7107068705f; q = q * t + (-0.142248368f); q = q * t + 0.127414796f; q = q * t;
    const f32x2 s = (v * v) * (-0.72134752044f);
    f32x2 e; e.x = __builtin_amdgcn_exp2f(s.x); e.y = __builtin_amdgcn_exp2f(s.y);
    const f32x2 m = v * (q * e), r = v - m;
    f32x2 o; o.x = v.x < 0.f ? m.x : r.x; o.y = v.y < 0.f ? m.y : r.y; return o;
}

template <int ACT  > struct EpiBf16 {
    static constexpr bool PERM = true, AFTER_DRAIN = false, MID = false; static_assert(ACT == 0 || ACT == 1, "EpiBf16: ACT is 0 (none) or 1 (gelu_pk)");
    bf16_t* O; int ldc; const float* bias; int split_cols; size_t split_stride; float scale0; int scale_t;
    __device__ __forceinline__ void operator()(const f32x4 (&acc)[2][2][4][2], const Unit& u, int wr, int wc, int fr, int fq) const {
        const int row0 = u.pm * BM + wr * 64 + fr; int colt = u.pn * BM; bf16_t* base = O;
        float sc = 1.f; if (split_cols) { const int t = colt / split_cols; base += (size_t)t * split_stride; colt -= t * split_cols; if (t == scale_t) sc = scale0; }
        const int col0 = colt + wc * 32 + 8 * fq, bcol0 = u.pn * BM + wc * 32 + 8 * fq;
        f32x4 bv[2][2];
#pragma unroll
        for (int bj = 0; bj < 2; ++bj)
#pragma unroll
            for (int n = 0; n < 2; ++n) bv[bj][n] = bias ? *(const f32x4*)(bias + bcol0 + bj * HALF + 4 * n) : (f32x4){0.f, 0.f, 0.f, 0.f};
#pragma unroll
        for (int ai = 0; ai < 2; ++ai)
#pragma unroll
            for (int m = 0; m < 4; ++m) { bf16_t* rowp = base + (size_t)(row0 + ai * HALF + m * 16) * ldc + col0;
#pragma unroll
                for (int bj = 0; bj < 2; ++bj) { f32x4 v0 = acc[ai][bj][m][0] + bv[bj][0], v1 = acc[ai][bj][m][1] + bv[bj][1];
                    if (ACT == 1) { f32x2 a = gelu_pk((f32x2){v0[0], v0[1]}), b = gelu_pk((f32x2){v0[2], v0[3]}), c = gelu_pk((f32x2){v1[0], v1[1]}), d = gelu_pk((f32x2){v1[2], v1[3]});
                        v0 = (f32x4){a.x, a.y, b.x, b.y}; v1 = (f32x4){c.x, c.y, d.x, d.y}; }
                    v0 = v0 * sc; v1 = v1 * sc; u32x4 w; w.x = cvt_pk_bf16(v0[0], v0[1]); w.y = cvt_pk_bf16(v0[2], v0[3]); w.z = cvt_pk_bf16(v1[0], v1[1]); w.w = cvt_pk_bf16(v1[2], v1[3]);
                    *(u32x4*)(rowp + bj * HALF) = w; } }
    }
};

struct PanelStats {
    unsigned* xbuf;
    unsigned* cnt;
    unsigned* tmo;
    int ntn; float eps;
    unsigned code;
    __device__ __forceinline__ bool run(const f32x4 (&v)[2][2][4][2], const Unit& u, int wr, int wc, int fr, int fq, PG8_LAS unsigned char* lds, int wid, int lane) const {
        typedef float f32x2v __attribute__((ext_vector_type(2)));
        PG8_LAS f32x2v* P = (PG8_LAS f32x2v*)lds;
        PG8_LAS f32x2v* S = (PG8_LAS f32x2v*)(lds + 8192);
        PG8_LAS unsigned* flag = (PG8_LAS unsigned*)(lds + 8192 + 2048);
#pragma unroll
        for (int ai = 0; ai < 2; ++ai)
#pragma unroll
            for (int m = 0; m < 4; ++m) {
                float s = 0.f;
#pragma unroll
                for (int bj = 0; bj < 2; ++bj)
#pragma unroll
                    for (int n = 0; n < 2; ++n) { const f32x4 x = v[ai][bj][m][n]; s += (x[0] + x[1]) + (x[2] + x[3]); }
                s += __shfl_xor(s, 16); s += __shfl_xor(s, 32);
                const float mw = s * (1.0f / 64.0f); float q = 0.f;
#pragma unroll
                for (int bj = 0; bj < 2; ++bj)
#pragma unroll
                    for (int n = 0; n < 2; ++n) { const f32x4 d = v[ai][bj][m][n] - mw; q += (d[0] * d[0] + d[1] * d[1]) + (d[2] * d[2] + d[3] * d[3]); }
                q += __shfl_xor(q, 16); q += __shfl_xor(q, 32);
                if (fq == 0) P[(ai * HALF + wr * 64 + m * 16 + fr) * 4 + wc] = (f32x2v){mw, q};
            }
        asm volatile("s_waitcnt lgkmcnt(0)" ::: "memory"); __builtin_amdgcn_s_barrier(); asm volatile("" ::: "memory");
#if defined(BROKEN_EXCHANGE_NO_WAIT)
#warning BROKEN CONTROL BUILD: the row-statistics exchange does not wait; results are wrong by design
        if (blockIdx.x >= 64) { const long long t0_ = clock64(); while (clock64() - t0_ < 60000) __builtin_amdgcn_s_sleep(8); }
#endif
        const int row = wid * 32 + (lane & 31);
        if (lane < 32) {
            const f32x2v a = P[row * 4 + 0], b = P[row * 4 + 1], c = P[row * 4 + 2], d = P[row * 4 + 3];
            const float mt = (a.x + b.x + c.x + d.x) * 0.25f;
            const float da = a.x - mt, db = b.x - mt, dc = c.x - mt, dd = d.x - mt;
            const float m2 = (a.y + b.y) + (c.y + d.y) + 64.0f * ((da * da + db * db) + (dc * dc + dd * dd));
            unsigned long long* slot = (unsigned long long*)xbuf + ((size_t)(u.pm * BM + row) * 4 + u.pn);
            __hip_atomic_store(slot, ((unsigned long long)__float_as_uint(m2) << 32) | __float_as_uint(mt), __ATOMIC_RELAXED, __HIP_MEMORY_SCOPE_AGENT);
        }
        asm volatile("s_waitcnt vmcnt(0)" ::: "memory");
        if (lane == 0) __hip_atomic_fetch_add(cnt + 64 * u.pm, 1u, __ATOMIC_RELAXED, __HIP_MEMORY_SCOPE_AGENT);
        if (wid == 0) {
            bool dead = false; const unsigned long long t0 = __builtin_amdgcn_s_memrealtime(); const unsigned want = 8u * (unsigned)ntn;
            for (;;) {
#if defined(BROKEN_EXCHANGE_NO_WAIT)
                break;
#endif
                if ((unsigned)__builtin_amdgcn_readfirstlane(__hip_atomic_load(cnt + 64 * u.pm, __ATOMIC_RELAXED, __HIP_MEMORY_SCOPE_AGENT)) >= want) break;
                if (__builtin_amdgcn_s_memrealtime() - t0 > 2000000ull) {
                    if (lane == 0) { unsigned expect = 0u; __hip_atomic_compare_exchange_strong(tmo + 1, &expect, code | (unsigned)(u.pm & 0xff), __ATOMIC_RELAXED, __ATOMIC_RELAXED, __HIP_MEMORY_SCOPE_AGENT);
                                     __hip_atomic_store(tmo, 1u, __ATOMIC_RELAXED, __HIP_MEMORY_SCOPE_AGENT); }
                    dead = true; break; }
                __builtin_amdgcn_s_sleep(2);
            }
            __builtin_amdgcn_fence(__ATOMIC_ACQUIRE, "agent");
            if (lane == 0) flag[0] = dead ? 1u : 0u;
        }
        asm volatile("s_waitcnt vmcnt(0) lgkmcnt(0)" ::: "memory"); __builtin_amdgcn_s_barrier(); asm volatile("" ::: "memory");
        const bool bad = flag[0] != 0u;
        if (lane < 32) {
            const unsigned long long* slot = (const unsigned long long*)xbuf + (size_t)(u.pm * BM + row) * 4; float mt[4], m2[4]; float ms = 0.f;
#pragma unroll
            for (int t = 0; t < 4; ++t) { if (t < ntn) { const unsigned long long w = __hip_atomic_load(slot + t, __ATOMIC_RELAXED, __HIP_MEMORY_SCOPE_AGENT); mt[t] = __uint_as_float((unsigned)w); m2[t] = __uint_as_float((unsigned)(w >> 32)); } else { mt[t] = 0.f; m2[t] = 0.f; } ms += mt[t]; }
            const float mean = ms / (float)ntn; float q = 0.f;
#pragma unroll
            for (int t = 0; t < 4; ++t) if (t < ntn) { const float dm = mt[t] - mean; q += m2[t] + 256.0f * dm * dm; }
            S[row] = (f32x2v){mean, 1.0f / sqrtf(q / (256.0f * (float)ntn) + eps)};
        }
        asm volatile("s_waitcnt lgkmcnt(0)" ::: "memory"); __builtin_amdgcn_s_barrier(); asm volatile("" ::: "memory");
        return bad;
    }
};
struct EpiLnRes {
    static constexpr bool PERM = false, AFTER_DRAIN = true, MID = false;
    const float* base; float* out; int ldc; const float* bias; PanelStats st; unsigned poison;
    __device__ __forceinline__ void fused(f32x4 (&acc)[2][2][4][2], const Unit& u, int wr, int wc, int fr, int fq, PG8_LAS unsigned char* lds, int wid, int lane) const {
        typedef float f32x2v __attribute__((ext_vector_type(2)));
        const PG8_LAS f32x2v* S = (const PG8_LAS f32x2v*)(lds + 8192);
        const int col0 = u.pn * BM + wc * 32 + 4 * fq;
#pragma unroll
        for (int bj = 0; bj < 2; ++bj)
#pragma unroll
            for (int n = 0; n < 2; ++n) { const f32x4 bv = bias ? *(const f32x4*)(bias + col0 + bj * HALF + n * 16) : (f32x4){0.f, 0.f, 0.f, 0.f};
#pragma unroll
                for (int ai = 0; ai < 2; ++ai)
#pragma unroll
                    for (int m = 0; m < 4; ++m) acc[ai][bj][m][n] += bv; }
        f32x4 pre[4][2][2];
#pragma unroll
        for (int m = 0; m < 4; ++m) { const size_t off = (size_t)(u.pm * BM + wr * 64 + m * 16 + fr) * ldc + col0;
#pragma unroll
            for (int bj = 0; bj < 2; ++bj)
#pragma unroll
                for (int n = 0; n < 2; ++n) pre[m][bj][n] = *(const f32x4*)(base + off + bj * HALF + n * 16); }
        const bool bad = st.run(acc, u, wr, wc, fr, fq, lds, wid, lane) || poison != 0u;
        const float qnan = __builtin_nanf("");
#pragma unroll
        for (int ai = 0; ai < 2; ++ai)
#pragma unroll
            for (int m = 0; m < 4; ++m) { const int r = ai * HALF + wr * 64 + m * 16 + fr; const f32x2v sr = S[r]; const size_t off = (size_t)(u.pm * BM + r) * ldc + col0;
#pragma unroll
                for (int bj = 0; bj < 2; ++bj)
#pragma unroll
                    for (int n = 0; n < 2; ++n) { const f32x4 bs = ai == 0 ? pre[m][bj][n] : *(const f32x4*)(base + off + bj * HALF + n * 16); f32x4 o = bs + (acc[ai][bj][m][n] - sr.x) * sr.y;
                        if (bad) o = (f32x4){qnan, qnan, qnan, qnan}; *(f32x4*)(out + off + bj * HALF + n * 16) = o; }
                if (m & 1) asm volatile("" ::: "memory"); }
    }
};
struct EpiLnResLn {
    static constexpr bool PERM = false, AFTER_DRAIN = true, MID = false;
    const float* base; float* out; bf16_t* xn; int ldc; const float* bias; PanelStats st1, st2; unsigned poison;
    __device__ __forceinline__ void fused(f32x4 (&acc)[2][2][4][2], const Unit& u, int wr, int wc, int fr, int fq, PG8_LAS unsigned char* lds, int wid, int lane) const {
        typedef float f32x2v __attribute__((ext_vector_type(2))); typedef unsigned u32x2v __attribute__((ext_vector_type(2)));
        const PG8_LAS f32x2v* S = (const PG8_LAS f32x2v*)(lds + 8192);
        const int col0 = u.pn * BM + wc * 32 + 4 * fq;
#pragma unroll
        for (int bj = 0; bj < 2; ++bj)
#pragma unroll
            for (int n = 0; n < 2; ++n) { const f32x4 bv = bias ? *(const f32x4*)(bias + col0 + bj * HALF + n * 16) : (f32x4){0.f, 0.f, 0.f, 0.f};
#pragma unroll
                for (int ai = 0; ai < 2; ++ai)
#pragma unroll
                    for (int m = 0; m < 4; ++m) acc[ai][bj][m][n] += bv; }
        bool bad = st1.run(acc, u, wr, wc, fr, fq, lds, wid, lane) || poison != 0u;
        const float qnan = __builtin_nanf("");
#pragma unroll
        for (int ai = 0; ai < 2; ++ai)
#pragma unroll
            for (int m = 0; m < 4; ++m) { const int r = ai * HALF + wr * 64 + m * 16 + fr; const f32x2v sr = S[r]; const size_t off = (size_t)(u.pm * BM + r) * ldc + col0;
#pragma unroll
                for (int bj = 0; bj < 2; ++bj)
#pragma unroll
                    for (int n = 0; n < 2; ++n) { const f32x4 bs = *(const f32x4*)(base + off + bj * HALF + n * 16); acc[ai][bj][m][n] = bs + (acc[ai][bj][m][n] - sr.x) * sr.y; }
                asm volatile("" : "+v"(acc[ai][0][m][0]), "+v"(acc[ai][0][m][1]), "+v"(acc[ai][1][m][0]), "+v"(acc[ai][1][m][1]));
                if (m & 1) asm volatile("" ::: "memory"); }
        const bool bad1 = bad;
        bad = st2.run(acc, u, wr, wc, fr, fq, lds, wid, lane) || bad;
#pragma unroll
        for (int ai = 0; ai < 2; ++ai)
#pragma unroll
            for (int m = 0; m < 4; ++m) { const int r = ai * HALF + wr * 64 + m * 16 + fr; const f32x2v sr = S[r]; const size_t off = (size_t)(u.pm * BM + r) * ldc + col0;
#pragma unroll
                for (int bj = 0; bj < 2; ++bj)
#pragma unroll
                    for (int n = 0; n < 2; ++n) { const f32x4 x1 = acc[ai][bj][m][n]; *(f32x4*)(out + off + bj * HALF + n * 16) = bad1 ? (f32x4){qnan, qnan, qnan, qnan} : x1;
                        const f32x4 o = (x1 - sr.x) * sr.y; u32x2v w; w.x = cvt_pk_bf16(o[0], o[1]); w.y = cvt_pk_bf16(o[2], o[3]);
                        if (bad) { w.x = 0x7fc07fc0u; w.y = 0x7fc07fc0u; } *(u32x2v*)(xn + off + bj * HALF + n * 16) = w; }
                asm volatile("" ::: "memory"); }
    }
};


__device__ __forceinline__ void mid_row_scale(f32x4 (&acc)[2][2][4][2], const float* ssq, const Unit& u, int wr, int fr) {
#pragma unroll
    for (int ai = 0; ai < 2; ++ai)
#pragma unroll
        for (int m = 0; m < 4; ++m) { const size_t row = (size_t)u.pm * BM + ai * HALF + wr * 64 + m * 16 + fr;
            const f32x4 s0 = *(const f32x4*)(ssq + row * 8), s1 = *(const f32x4*)(ssq + row * 8 + 4);
            const float ss = ((s0[0] + s0[1]) + (s0[2] + s0[3])) + ((s1[0] + s1[1]) + (s1[2] + s1[3]));
            const float rs = 1.0f / sqrtf(ss * (1.0f / 512.0f) + 1e-5f);
#pragma unroll
            for (int bj = 0; bj < 2; ++bj)
#pragma unroll
                for (int n = 0; n < 2; ++n) acc[ai][bj][m][n] = acc[ai][bj][m][n] * rs; }
}
struct EpiF32 {
    static constexpr bool PERM = false, AFTER_DRAIN = false, MID = true; static constexpr int MID_T = 8;
    float* O; int ldc; const float* ssq;
    __device__ __forceinline__ void mid(f32x4 (&acc)[2][2][4][2], const Unit& u, int wr, int wc, int fr, int fq) const { mid_row_scale(acc, ssq, u, wr, fr); }
    __device__ __forceinline__ void operator()(const f32x4 (&acc)[2][2][4][2], const Unit& u, int wr, int wc, int fr, int fq) const {
        const int col0 = u.pn * BM + wc * 32 + 4 * fq;
#pragma unroll
        for (int ai = 0; ai < 2; ++ai)
#pragma unroll
            for (int m = 0; m < 4; ++m) { float* rowp = O + (size_t)(u.pm * BM + ai * HALF + wr * 64 + m * 16 + fr) * ldc + col0;
#pragma unroll
                for (int bj = 0; bj < 2; ++bj)
#pragma unroll
                    for (int n = 0; n < 2; ++n) *(f32x4*)(rowp + bj * HALF + n * 16) = acc[ai][bj][m][n]; }
    }
};

template <class Epi, class Sched, bool ALIGN_EPI = false, bool SP2 = false>
__device__ __forceinline__ void gemm_phase(PG8_LAS unsigned char* lds, const Gemm g, const Sched& S, const Epi& E) {
    const int tid = threadIdx.x, wid = __builtin_amdgcn_readfirstlane(tid >> 6), lane = tid & 63, wr = wid >> 2, wc = wid & 3, fr = lane & 15, fq = lane >> 4;
    const int K = g.K, nt = K / BK;
    unsigned voffA[2], voffB[2];
#pragma unroll
    for (int i = 0; i < 2; ++i) { int R, C; stage_rc(tid * 16 + i * 8192, R, C); const int Rb = Epi::PERM ? ((R & ~31) + perm32(R & 31)) : R;
        voffA[i] = (unsigned)(R * K + C) * 2u; voffB[i] = (unsigned)(Rb * K + C) * 2u; }
    const size_t kstep = (size_t)(BK * 2);
    const size_t hstep = (size_t)HALF * K * 2;
    const size_t tstep = 2 * hstep;
    const unsigned ldsw = (unsigned)wid * 1024u;
    const int aoff = lds_byte(wr * 64 + fr, fq * 8), boff = lds_byte(wc * 32 + fr, fq * 8);
#define PG8_SA(b, h) (((b) * 2 + (h)) * HTB)
#define PG8_SB(b, h) ((4 + (b) * 2 + (h)) * HTB)
#define PG8_STAGE(bufoff, gbase, voff) do { _Pragma("unroll") for (int _i = 0; _i < 2; ++_i) \
        __builtin_amdgcn_global_load_lds((const unsigned*)((const char*)(gbase) + (voff)[_i]), (PG8_LAS unsigned*)(lds + (bufoff) + ldsw + _i * 8192), 16, 0, 0); } while (0)
#define PG8_LDA(dst, b, h) do { _Pragma("unroll") for (int m = 0; m < 4; ++m) _Pragma("unroll") for (int k = 0; k < 2; ++k) dst[m][k] = *(const PG8_LAS bf16x8*)(lds + PG8_SA(b, h) + aoff + m * 2048 + k * 1024); } while (0)
#define PG8_LDB(dst, b, h) do { _Pragma("unroll") for (int n = 0; n < 2; ++n) _Pragma("unroll") for (int k = 0; k < 2; ++k) dst[n][k] = *(const PG8_LAS bf16x8*)(lds + PG8_SB(b, h) + boff + n * 2048 + k * 1024); } while (0)
#define PG8_MMA(ai, bj, At, Bt) do { __builtin_amdgcn_s_setprio(1); _Pragma("unroll") for (int m = 0; m < 4; ++m) _Pragma("unroll") for (int n = 0; n < 2; ++n) _Pragma("unroll") for (int k = 0; k < 2; ++k) \
        acc[ai][bj][m][n] = __builtin_amdgcn_mfma_f32_16x16x32_bf16(Bt[n][k], At[m][k], acc[ai][bj][m][n], 0, 0, 0); __builtin_amdgcn_s_setprio(0); } while (0)
#define PG8_WAIT_V(n) asm volatile("s_waitcnt vmcnt(" #n ")" ::: "memory")
#define PG8_WAIT_L(n) asm volatile("s_waitcnt lgkmcnt(" #n ")" ::: "memory")
#define PG8_BAR __builtin_amdgcn_s_barrier()
#define PG8_SCHED __builtin_amdgcn_sched_barrier(0)
    Unit cur, nxt; int ui = 0;
    if (!S.next(0, cur)) return;
    f32x4 acc[2][2][4][2];
#pragma unroll
    for (int a = 0; a < 2; ++a)
#pragma unroll
        for (int b = 0; b < 2; ++b)
#pragma unroll
            for (int m = 0; m < 4; ++m)
#pragma unroll
                for (int n = 0; n < 2; ++n) acc[a][b][m][n] = (f32x4){0.f, 0.f, 0.f, 0.f};
    bf16x8 At[4][2], B0[2][2], B1[2][2];
    const char* cA = (const char*)g.A + (size_t)cur.pm * tstep; const char* cB = (const char*)g.Bt + (size_t)cur.pn * tstep;
    S.a_ready(cur);
    if constexpr (SP2) {
        PG8_STAGE(PG8_SB(0, 0), cB, voffB); PG8_STAGE(PG8_SB(0, 1), cB + hstep, voffB); PG8_STAGE(PG8_SA(0, 0), cA, voffA); PG8_STAGE(PG8_SA(0, 1), cA + hstep, voffA);
        if (wr == 1) PG8_BAR;
        PG8_WAIT_V(2); PG8_BAR;
        PG8_STAGE(PG8_SB(1, 0), cB + kstep, voffB); PG8_STAGE(PG8_SA(1, 0), cA + kstep, voffA); PG8_STAGE(PG8_SB(1, 1), cB + hstep + kstep, voffB);
        PG8_WAIT_V(6); PG8_BAR;
    } else {
        PG8_STAGE(PG8_SB(0, 0), cB, voffB); PG8_STAGE(PG8_SA(0, 0), cA, voffA); PG8_STAGE(PG8_SB(0, 1), cB + hstep, voffB); PG8_STAGE(PG8_SA(0, 1), cA + hstep, voffA);
        if (wr == 1) PG8_BAR;
        PG8_WAIT_V(4); PG8_BAR;
        PG8_STAGE(PG8_SB(1, 0), cB + kstep, voffB); PG8_STAGE(PG8_SA(1, 0), cA + kstep, voffA); PG8_STAGE(PG8_SB(1, 1), cB + hstep + kstep, voffB);
        PG8_WAIT_V(6); PG8_BAR;
    }
    for (;;) {
        const bool has_next = S.next(ui + 1, nxt);
        const char* nA = has_next ? (const char*)g.A + (size_t)nxt.pm * tstep : cA; const char* nB = has_next ? (const char*)g.Bt + (size_t)nxt.pn * tstep : cB;
        for (int t = 0; t < nt; t += 2) {
            if constexpr (Epi::MID) { if (t == Epi::MID_T) E.mid(acc, cur, wr, wc, fr, fq); }
            const bool last = (t == nt - 2);
            const char* a1 = cA + (size_t)(t + 1) * kstep;
            const char* a2 = last ? nA : cA + (size_t)(t + 2) * kstep; const char* b2 = last ? nB : cB + (size_t)(t + 2) * kstep;
            const char* a3 = a2 + kstep; const char* b3 = b2 + kstep;
            if (last && has_next) S.a_ready(nxt);
            if constexpr (SP2) {
            PG8_LDB(B0, 0, 0); PG8_LDB(B1, 0, 1); PG8_SCHED; PG8_LDA(At, 0, 0); PG8_STAGE(PG8_SA(1, 1), a1 + hstep, voffA);
            PG8_WAIT_V(8); PG8_WAIT_L(0); PG8_BAR; PG8_MMA(0, 0, At, B0); PG8_MMA(0, 1, At, B1); PG8_BAR; PG8_SCHED;
            PG8_LDA(At, 0, 1); PG8_STAGE(PG8_SB(0, 0), b2, voffB); PG8_STAGE(PG8_SB(0, 1), b2 + hstep, voffB); PG8_STAGE(PG8_SA(0, 0), a2, voffA);
            PG8_WAIT_V(8); PG8_WAIT_L(0); PG8_BAR; PG8_MMA(1, 0, At, B0); PG8_MMA(1, 1, At, B1); PG8_BAR; PG8_SCHED;
            PG8_LDB(B0, 1, 0); PG8_LDB(B1, 1, 1); PG8_SCHED; PG8_LDA(At, 1, 0); PG8_STAGE(PG8_SA(0, 1), a2 + hstep, voffA);
            PG8_WAIT_V(8); PG8_WAIT_L(0); PG8_BAR; PG8_MMA(0, 0, At, B0); PG8_MMA(0, 1, At, B1); PG8_BAR; PG8_SCHED;
            PG8_LDA(At, 1, 1); PG8_STAGE(PG8_SB(1, 0), b3, voffB); PG8_STAGE(PG8_SB(1, 1), b3 + hstep, voffB); PG8_STAGE(PG8_SA(1, 0), a3, voffA);
            PG8_WAIT_V(8); PG8_WAIT_L(0); PG8_BAR; PG8_MMA(1, 0, At, B0); PG8_MMA(1, 1, At, B1); PG8_BAR; PG8_SCHED;
            } else {
            PG8_LDB(B0, 0, 0); PG8_SCHED; PG8_LDA(At, 0, 0); PG8_STAGE(PG8_SA(1, 1), a1 + hstep, voffA);
            PG8_WAIT_L(8); PG8_BAR; PG8_WAIT_L(0); PG8_MMA(0, 0, At, B0); PG8_BAR; PG8_SCHED;
            PG8_LDB(B1, 0, 1); PG8_STAGE(PG8_SB(0, 0), b2, voffB);
            PG8_BAR; PG8_WAIT_L(0); PG8_MMA(0, 1, At, B1); PG8_BAR;
            PG8_LDA(At, 0, 1); PG8_STAGE(PG8_SA(0, 0), a2, voffA);
            PG8_BAR; PG8_WAIT_L(0); PG8_MMA(1, 0, At, B0); PG8_BAR; PG8_SCHED;
            PG8_STAGE(PG8_SB(0, 1), b2 + hstep, voffB);
            PG8_WAIT_V(6); PG8_BAR; PG8_MMA(1, 1, At, B1); PG8_BAR;
            PG8_LDB(B0, 1, 0); PG8_SCHED; PG8_LDA(At, 1, 0); PG8_STAGE(PG8_SA(0, 1), a2 + hstep, voffA);
            PG8_WAIT_L(8); PG8_BAR; PG8_WAIT_L(0); PG8_MMA(0, 0, At, B0); PG8_BAR; PG8_SCHED;
            PG8_LDB(B1, 1, 1); PG8_STAGE(PG8_SB(1, 0), b3, voffB);
            PG8_BAR; PG8_WAIT_L(0); PG8_MMA(0, 1, At, B1); PG8_BAR;
            PG8_LDA(At, 1, 1); PG8_STAGE(PG8_SA(1, 0), a3, voffA);
            PG8_BAR; PG8_WAIT_L(0); PG8_MMA(1, 0, At, B0); PG8_BAR; PG8_SCHED;
            PG8_STAGE(PG8_SB(1, 1), b3 + hstep, voffB);
            PG8_WAIT_V(6); PG8_BAR; PG8_MMA(1, 1, At, B1); PG8_BAR;
            }
        }
        if constexpr (ALIGN_EPI) { if (wr == 0) PG8_BAR; }
        if constexpr (!Epi::AFTER_DRAIN) { E(acc, cur, wr, wc, fr, fq); S.done(cur); }
        if (!has_next) break;
#pragma unroll
        for (int a = 0; a < 2; ++a)
#pragma unroll
            for (int b = 0; b < 2; ++b)
#pragma unroll
                for (int m = 0; m < 4; ++m)
#pragma unroll
                    for (int n = 0; n < 2; ++n) acc[a][b][m][n] = (f32x4){0.f, 0.f, 0.f, 0.f};
        cur = nxt; cA = nA; cB = nB; ++ui;
        if constexpr (ALIGN_EPI) { if (wr == 1) PG8_BAR; }
    }
    PG8_WAIT_V(0);
    if constexpr (!ALIGN_EPI) { if (wr == 0) PG8_BAR; }
    PG8_BAR;
    if constexpr (Epi::AFTER_DRAIN) { E.fused(acc, cur, wr, wc, fr, fq, lds, wid, lane); S.done(cur); }
#undef PG8_SA
#undef PG8_SB
#undef PG8_STAGE
#undef PG8_LDA
#undef PG8_LDB
#undef PG8_MMA
#undef PG8_WAIT_V
#undef PG8_WAIT_L
#undef PG8_BAR
#undef PG8_SCHED
}
}

#ifndef PG8_SP2
#define PG8_SP2 true
#endif
#ifndef PG8_ALIGN
#define PG8_ALIGN true
#endif

constexpr int NBATCH = 4, SEQ = 8192, DM = 1024, MTOK = NBATCH * SEQ, DEPTH = 2;
constexpr int DL = 512, DA = 512, NH = 8, HD = 64, NBLK = 8, BW = 64, NIN = 3080, NPROJ = 3072;
constexpr float ALPHA = 1.4142135623730951f, LN_EPS = 1e-5f, LOG2E = 1.4426950408889634f, C2Q = 0.125f * 1.4426950408889634f;
constexpr int NWAVES = 8;

constexpr size_t MiB = 1u << 20;
constexpr size_t WS_CTL = 0, CTL_ZERO_BYTES = 1 * MiB;
constexpr size_t WS_MOD = 1 * MiB;
constexpr size_t WS_WFL = 2 * MiB;
constexpr size_t WS_WG = 3 * MiB;
constexpr size_t WS_LOGF = 4 * MiB;
constexpr size_t WS_SSQ = 5 * MiB;
constexpr size_t WS_AGG = 6 * MiB;
constexpr size_t WS_XCH = 8 * MiB;
constexpr size_t WS_DCUM = 11 * MiB;
constexpr size_t WS_WIN = 16 * MiB;
constexpr size_t WS_WO = 28 * MiB;
constexpr size_t WS_XN = 32 * MiB;
constexpr size_t WS_PROJ = 96 * MiB;
constexpr size_t WS_Y = 288 * MiB;
constexpr size_t WS_X1 = 352 * MiB;
constexpr size_t WS_END = 480 * MiB;
constexpr size_t WS_HL = WS_XN;
constexpr size_t WS_YO = WS_PROJ;
constexpr size_t PROJ_STRIDE = (size_t)MTOK * 512;

constexpr int LDS_BYTES = 147456;

#define GAS __attribute__((address_space(1)))
#define LAS __attribute__((address_space(3)))
typedef unsigned short bf16;
typedef unsigned v4u __attribute__((ext_vector_type(4)));
typedef float f32x4 __attribute__((ext_vector_type(4)));
typedef short bf16x8 __attribute__((ext_vector_type(8)));
#define LDS_WAIT() asm volatile("s_waitcnt lgkmcnt(0)" ::: "memory")
#define VM_WAIT() asm volatile("s_waitcnt vmcnt(0)" ::: "memory")
__device__ __forceinline__ unsigned f2bf(float f) { unsigned u = __builtin_bit_cast(unsigned, f); return (u + 0x7fffu + ((u >> 16) & 1u)) >> 16; }
__device__ __forceinline__ unsigned pk2(float lo, float hi) { return f2bf(lo) | (f2bf(hi) << 16); }
__device__ __forceinline__ float bf2f(unsigned short v) { return __builtin_bit_cast(float, (unsigned)v << 16); }
__device__ __forceinline__ float wave_sum(float v) {
#pragma unroll
    for (int o = 1; o < 64; o <<= 1) v += __shfl_xor(v, o);
    return v;
}
__device__ __forceinline__ float silu_f(float v) { return v / (1.0f + __expf(-v)); }
__device__ __forceinline__ float sigmoid_f(float v) { return 1.0f / (1.0f + __expf(-v)); }

struct Args { const float* in[18]; float* out; unsigned char* ws; int ph_lo, ph_hi, layer, pad; };
enum { I_X = 0, I_C, I_WADA, I_BADA, I_WIN, I_BFG, I_CONVW, I_CONVB, I_WGA, I_BGA, I_WGX, I_BGX, I_LAM, I_NLRU, I_NATT, I_WOUT, I_LNG, I_LNB };

__device__ __forceinline__ void p0_mod(const float* c, const float* w_ada, const float* b_ada, float* mod, LAS unsigned char* lds, int j, int tid) {
    const int lane = tid & 63, wave = tid >> 6;
    LAS f32x4* cact = (LAS f32x4*)lds;
    LAS float* red = (LAS float*)(lds + 16384);
    for (int k = tid; k < 1024; k += 512) {
        f32x4 v; v[0] = silu_f(c[k]); v[1] = silu_f(c[1024 + k]); v[2] = silu_f(c[2048 + k]); v[3] = silu_f(c[3072 + k]);
        cact[k] = v;
    }
    __syncthreads();
    const int col = j * 64 + lane, l = col / 3072, n = col % 3072;
    const float* W = w_ada + (size_t)l * 1024 * 3072 + n;
    float a0 = 0.f, a1 = 0.f, a2 = 0.f, a3 = 0.f;
    const int kb = wave * 128;
#pragma unroll 16
    for (int k = kb; k < kb + 128; ++k) { const float w = W[(size_t)k * 3072]; const f32x4 cv = cact[k]; a0 += cv[0] * w; a1 += cv[1] * w; a2 += cv[2] * w; a3 += cv[3] * w; }
    red[(wave * 4 + 0) * 64 + lane] = a0; red[(wave * 4 + 1) * 64 + lane] = a1; red[(wave * 4 + 2) * 64 + lane] = a2; red[(wave * 4 + 3) * 64 + lane] = a3;
    __syncthreads();
    if (tid < 256) {
        const int b = tid >> 6; float s = 0.f;
#pragma unroll
        for (int w = 0; w < 8; ++w) s += red[(w * 4 + b) * 64 + lane];
        mod[(size_t)(l * 4 + b) * 3072 + n] = s + b_ada[l * 3072 + n];
    }
    __syncthreads();
}
__device__ __forceinline__ void transpose_item(const float* W, int ldw, int nblk, bf16* WT, int kperm, LAS float* scr, int item, int lane) {
    const int kb = item / nblk, nb = item % nblk, k0 = 64 * kb, n0 = 32 * nb;
#pragma unroll 8
    for (int i = 0; i < 32; ++i) { const int kk = 2 * i + (lane >> 5); scr[kk * 33 + (lane & 31)] = W[(size_t)(k0 + kk) * ldw + n0 + (lane & 31)]; }
    LDS_WAIT(); asm volatile("" ::: "memory");
    const int c = lane & 7, kd = (k0 + kperm) & 1023;
#pragma unroll
    for (int jj = 0; jj < 4; ++jj) { const int n = (lane >> 3) + 8 * jj; const LAS float* s = scr + (8 * c) * 33 + n;
        v4u o; o.x = pk2(s[0 * 33], s[1 * 33]); o.y = pk2(s[2 * 33], s[3 * 33]); o.z = pk2(s[4 * 33], s[5 * 33]); o.w = pk2(s[6 * 33], s[7 * 33]);
        *(v4u*)(WT + (size_t)(n0 + n) * 1024 + kd + 8 * c) = o; }
    LDS_WAIT(); asm volatile("" ::: "memory");
}
__device__ __forceinline__ void phase_p0a(const Args& a, LAS unsigned char* lds, int tid) {
    const int lane = tid & 63, wave = __builtin_amdgcn_readfirstlane(tid >> 6);
    const int G = gridDim.x, wg = blockIdx.x;
    for (int j = wg; j < 96; j += G) p0_mod(a.in[I_C], a.in[I_WADA], a.in[I_BADA], (float*)(a.ws + WS_MOD), lds, j, tid);
    LAS float* scr = (LAS float*)(lds + wave * 16384);
    const int gw = wg * NWAVES + wave, NGW = G * NWAVES;
    constexpr int I_IN = 16 * 96, I_O = 16 * 32, I_L = I_IN + I_O;
    for (int it = gw; it < DEPTH * I_L; it += NGW) {
        const int l = it / I_L, r = it % I_L;
        if (r < I_IN) transpose_item(a.in[I_WIN] + (size_t)l * 1024 * NIN, NIN, 96, (bf16*)(a.ws + WS_WIN) + (size_t)l * NPROJ * 1024, 0, scr, r, lane);
        else transpose_item(a.in[I_WOUT] + (size_t)l * 1024 * 1024, 1024, 32, (bf16*)(a.ws + WS_WO) + (size_t)l * 1024 * 1024, 512, scr, r - I_IN, lane);
    }
    const int gt = wg * 512 + tid, NGT = G * 512;
    bf16* wfl = (bf16*)(a.ws + WS_WFL);
    for (int e = gt; e < DEPTH * 16 * 1024; e += NGT) { const int l = e >> 14, jj = (e >> 10) & 15, k = e & 1023;
        const float v = jj < 8 ? a.in[I_WIN][(size_t)l * 1024 * NIN + (size_t)k * NIN + NPROJ + jj] : 0.f; wfl[e] = (bf16)f2bf(v); }
    bf16* wg_t = (bf16*)(a.ws + WS_WG);
    for (int e = gt; e < DEPTH * 2 * 8 * 64 * 64; e += NGT) { const int i = e & 63, o = (e >> 6) & 63, n = (e >> 12) & 7, g = (e >> 15) & 1, l = e >> 16;
        const float* src = (g == 0 ? a.in[I_WGA] : a.in[I_WGX]) + ((size_t)(l * 8 + n) * 64 + i) * 64 + o; wg_t[e] = (bf16)f2bf(*src); }
}
__device__ __forceinline__ void lnmod_row(const float* xrow, bf16* orow, const float* modb, int lane) {
    const f32x4* xr = (const f32x4*)xrow + lane;
    f32x4 v[4]; float s = 0.f;
#pragma unroll
    for (int j = 0; j < 4; ++j) { v[j] = xr[64 * j]; s += (v[j][0] + v[j][1]) + (v[j][2] + v[j][3]); }
    const float mean = wave_sum(s) * (1.f / DM); float s2 = 0.f;
#pragma unroll
    for (int j = 0; j < 4; ++j) { v[j] = v[j] - mean; s2 += (v[j][0] * v[j][0] + v[j][1] * v[j][1]) + (v[j][2] * v[j][2] + v[j][3] * v[j][3]); }
    const float rstd = 1.f / sqrtf(wave_sum(s2) * (1.f / DM) + LN_EPS);
    unsigned long long* o8 = (unsigned long long*)orow + lane;
#pragma unroll
    for (int j = 0; j < 4; ++j) { const int col = 4 * lane + 256 * j; const f32x4 sh = *(const f32x4*)(modb + col), sc = *(const f32x4*)(modb + 1024 + col);
        const f32x4 y = v[j] * rstd * (sc + 1.0f) + sh;
        o8[64 * j] = (unsigned long long)pk2(y[0], y[1]) | ((unsigned long long)pk2(y[2], y[3]) << 32); }
}
__device__ __forceinline__ void phase_p0b(const Args& a, int tid) {
    const int lane = tid & 63, wave = tid >> 6, gw = blockIdx.x * NWAVES + wave, NGW = gridDim.x * NWAVES;
    const float* mod = (const float*)(a.ws + WS_MOD);
    for (int m = gw; m < MTOK; m += NGW) lnmod_row(a.in[I_X] + (size_t)m * DM, (bf16*)(a.ws + WS_XN) + (size_t)m * DM, mod + (size_t)(m / SEQ) * 3072, lane);
}
__device__ __forceinline__ void fl_phase(const bf16* XN, const bf16* Wfl, const float* bfg, float* logf, int gw, int NGW, int lane) {
    const int fr = lane & 15, fq = lane >> 4;
    for (int rt = gw; rt < MTOK / 16; rt += NGW) {
        const bf16* ap = XN + (size_t)(rt * 16 + fr) * DM + fq * 8;
        const bf16* bp = Wfl + fr * 1024 + fq * 8;
        f32x4 acc = {0.f, 0.f, 0.f, 0.f};
#pragma unroll 8
        for (int kk = 0; kk < 32; ++kk) { const bf16x8 av = *(const bf16x8*)(ap + kk * 32); const bf16x8 bv = *(const bf16x8*)(bp + kk * 32);
            acc = __builtin_amdgcn_mfma_f32_16x16x32_bf16(av, bv, acc, 0, 0, 0); }
        if (fr < 8) { const float bb = bfg[fr]; f32x4 o;
#pragma unroll
            for (int r = 0; r < 4; ++r) { const float z = acc[r] + bb; o[r] = fminf(z, 0.f) - log1pf(__expf(-fabsf(z))); }
            const int m0 = rt * 16 + 4 * fq, b = m0 / SEQ, t = m0 % SEQ;
            *(f32x4*)(logf + (size_t)(b * NH + fr) * SEQ + t) = o; }
    }
}
__device__ __forceinline__ void block_cumsum_8192(const float* src, LAS float* wsum, int tid, float (&p)[16]) {
    const int lane = tid & 63, wave = tid >> 6;
    const f32x4* s4 = (const f32x4*)(src + 16 * tid);
    float run = 0.f;
#pragma unroll
    for (int j = 0; j < 4; ++j) { const f32x4 v = s4[j];
#pragma unroll
        for (int e = 0; e < 4; ++e) { run += v[e]; p[4 * j + e] = run; } }
    const float tot = run; float inc = tot;
#pragma unroll
    for (int o = 1; o < 64; o <<= 1) { const float t = __shfl_up(inc, o); if (lane >= o) inc += t; }
    if (lane == 63) wsum[wave] = inc;
    __syncthreads();
    float off = inc - tot;
    for (int w = 0; w < wave; ++w) off += wsum[w];
#pragma unroll
    for (int e = 0; e < 16; ++e) p[e] += off;
    __syncthreads();
}

__global__ void __launch_bounds__(NWAVES * 64, 2) mk(Args a) {
    extern __shared__ __attribute__((aligned(16))) unsigned char lds_raw[];
    LAS unsigned char* lds = (LAS unsigned char*)lds_raw;
    const int tid = threadIdx.x, lane = tid & 63, wave = __builtin_amdgcn_readfirstlane(tid >> 6);
    const int G = gridDim.x;
    const int lo = a.ph_lo, hi = a.ph_hi;
#define IN(k) (lo <= (k) && (k) < hi)
    if (IN(0)) phase_p0a(a, lds, tid);
    if (IN(1)) phase_p0b(a, tid);
    const int l = a.layer;
    bf16* XN = (bf16*)(a.ws + WS_XN); bf16* PROJ = (bf16*)(a.ws + WS_PROJ); bf16* Y = (bf16*)(a.ws + WS_Y);
    if (IN(2)) {
        fl_phase(XN, (const bf16*)(a.ws + WS_WFL) + (size_t)l * 16 * 1024, a.in[I_BFG] + l * NH, (float*)(a.ws + WS_LOGF), blockIdx.x * NWAVES + wave, G * NWAVES, lane);
        pg8::Gemm g{XN, (const bf16*)(a.ws + WS_WIN) + (size_t)l * NPROJ * 1024, MTOK, NPROJ, DM}; pg8::StaticOrder S; S.init(MTOK, NPROJ, G, (int)blockIdx.x);
        pg8::EpiBf16<0> E{PROJ, 512, nullptr, 512, PROJ_STRIDE, C2Q, 2};
        pg8::gemm_phase<pg8::EpiBf16<0>, pg8::StaticOrder, true, true>((PG8_LAS unsigned char*)lds, g, S, E);
    }
    if (IN(4)) {
        pg8::Gemm g{Y, (const bf16*)(a.ws + WS_WO) + (size_t)l * 1024 * 1024, MTOK, DM, DM}; pg8::StaticOrder S; S.init(MTOK, DM, G, (int)blockIdx.x);
        pg8::EpiF32 E{(float*)(a.ws + WS_YO), DM, (const float*)(a.ws + WS_SSQ)};
        pg8::gemm_phase<pg8::EpiF32, pg8::StaticOrder, true, true>((PG8_LAS unsigned char*)lds, g, S, E);
    }
#undef IN
}

__global__ void __launch_bounds__(512) k_cumsum(const float* logf, float* dcum) {
    __shared__ float wsum[8];
    float p[16];
    block_cumsum_8192(logf + (size_t)blockIdx.x * SEQ, (LAS float*)wsum, threadIdx.x, p);
    f32x4* o = (f32x4*)(dcum + (size_t)blockIdx.x * SEQ + 16 * threadIdx.x);
#pragma unroll
    for (int j = 0; j < 4; ++j) o[j] = (f32x4){p[4 * j], p[4 * j + 1], p[4 * j + 2], p[4 * j + 3]};
}
__global__ void __launch_bounds__(256) k_attn_naive(const bf16* Q, const bf16* K, const bf16* V, const bf16* ZA, const float* dcum, const float* g_a, bf16* Y, float* ssq) {
    __shared__ float Ks[32][64]; __shared__ float Vs[32][64]; __shared__ float dk[32];
    const int tid = threadIdx.x; const int bh = blockIdx.x >> 5, qb = blockIdx.x & 31; const int b = bh >> 3, h = bh & 7;
    const int i = qb * 256 + tid; const size_t m = (size_t)b * SEQ + i;
    float q[64], o[64];
#pragma unroll
    for (int c = 0; c < 8; ++c) { const bf16x8 raw = *(const bf16x8*)(Q + m * 512 + h * 64 + c * 8);
#pragma unroll
        for (int e = 0; e < 8; ++e) { q[c * 8 + e] = bf2f((unsigned short)raw[e]); o[c * 8 + e] = 0.f; } }
    const float dq = dcum[(size_t)bh * SEQ + i] * LOG2E;
    float mrun = -INFINITY, lsum = 0.f;
    const int ntile = (qb * 256 + 256) / 32;
    for (int kt = 0; kt < ntile; ++kt) {
        __syncthreads();
        { const int r = tid >> 3, c8 = tid & 7; const size_t off = ((size_t)b * SEQ + kt * 32 + r) * 512 + h * 64 + c8 * 8;
          const bf16x8 rk = *(const bf16x8*)(K + off), rv = *(const bf16x8*)(V + off);
#pragma unroll
          for (int e = 0; e < 8; ++e) { Ks[r][c8 * 8 + e] = bf2f((unsigned short)rk[e]); Vs[r][c8 * 8 + e] = bf2f((unsigned short)rv[e]); } }
        if (tid < 32) dk[tid] = dcum[(size_t)bh * SEQ + kt * 32 + tid] * LOG2E;
        __syncthreads();
        if (kt * 32 <= i) {
#pragma unroll 1
            for (int j0 = 0; j0 < 32; j0 += 4) {
                float s[4]; float mx = -INFINITY;
#pragma unroll
                for (int jj = 0; jj < 4; ++jj) { float d = 0.f;
#pragma unroll
                    for (int dd = 0; dd < 64; ++dd) d += q[dd] * Ks[j0 + jj][dd];
                    s[jj] = (kt * 32 + j0 + jj <= i) ? d + dq - dk[j0 + jj] : -INFINITY; mx = fmaxf(mx, s[jj]); }
                if (mx > -INFINITY) {
                    const float mn = fmaxf(mrun, mx), al = exp2f(mrun - mn); mrun = mn; lsum *= al;
#pragma unroll
                    for (int dd = 0; dd < 64; ++dd) o[dd] *= al;
#pragma unroll
                    for (int jj = 0; jj < 4; ++jj) { const float p = exp2f(s[jj] - mn); lsum += p;
#pragma unroll
                        for (int dd = 0; dd < 64; ++dd) o[dd] += p * Vs[j0 + jj][dd]; }
                }
            }
        }
    }
    const float rl = 1.0f / lsum; float ss = 0.f;
#pragma unroll
    for (int dd = 0; dd < 64; ++dd) { o[dd] *= rl; ss += o[dd] * o[dd]; }
    ssq[m * 8 + h] = ss;
#pragma unroll
    for (int c = 0; c < 8; ++c) { const bf16x8 zr = *(const bf16x8*)(ZA + m * 512 + h * 64 + c * 8); v4u w;
        float y[8];
#pragma unroll
        for (int e = 0; e < 8; ++e) y[e] = o[c * 8 + e] * g_a[h * 64 + c * 8 + e] * silu_f(bf2f((unsigned short)zr[e]));
        w.x = pk2(y[0], y[1]); w.y = pk2(y[2], y[3]); w.z = pk2(y[4], y[5]); w.w = pk2(y[6], y[7]);
        *(v4u*)(Y + m * 1024 + h * 64 + c * 8) = w; }
}
__global__ void __launch_bounds__(64) k_lru_naive(const bf16* XR, const float* conv_w, const float* conv_b, const float* w_a, const float* b_a, const float* w_x, const float* b_x, const float* lam, float* hL) {
    __shared__ float xs[2][64];
    const int lane = threadIdx.x, b = blockIdx.x >> 3, n = blockIdx.x & 7, ch = n * 64 + lane;
    float wa[64], wx[64];
#pragma unroll
    for (int k = 0; k < 64; ++k) { wa[k] = w_a[((size_t)n * 64 + k) * 64 + lane]; wx[k] = w_x[((size_t)n * 64 + k) * 64 + lane]; }
    const float cw0 = conv_w[0 * 512 + ch], cw1 = conv_w[1 * 512 + ch], cw2 = conv_w[2 * 512 + ch], cw3 = conv_w[3 * 512 + ch], cb = conv_b[ch];
    const float ba = b_a[ch], bx = b_x[ch], lm = lam[ch];
    const float sp = fmaxf(-lm, 0.f) + log1pf(__expf(-fabsf(lm)));
    float h = 0.f, x0 = 0.f, x1 = 0.f, x2 = 0.f;
    for (int t0 = 0; t0 < SEQ; t0 += 32) {
        float xr[32];
#pragma unroll
        for (int tt = 0; tt < 32; ++tt) xr[tt] = bf2f(XR[((size_t)b * SEQ + t0 + tt) * 512 + ch]);
#pragma unroll
        for (int tt = 0; tt < 32; ++tt) {
            const float xc = cb + cw0 * x0 + cw1 * x1 + cw2 * x2 + cw3 * xr[tt];
            x0 = x1; x1 = x2; x2 = xr[tt];
            xs[tt & 1][lane] = xc;
            __syncthreads();
            float ra = ba, rx = bx;
#pragma unroll
            for (int k = 0; k < 64; ++k) { const float xk = xs[tt & 1][k]; ra += xk * wa[k]; rx += xk * wx[k]; }
            const float r = sigmoid_f(ra), ig = sigmoid_f(rx);
            const float log_a = -8.0f * r * sp, av = __expf(log_a), mult = sqrtf(-expm1f(2.0f * log_a));
            h = av * h + mult * (ig * xc);
            hL[((size_t)b * SEQ + t0 + tt) * 512 + ch] = h;
        }
    }
}
__global__ void __launch_bounds__(512) k_ynorm_r(const float* hL, const bf16* ZR, const float* g_r, bf16* Y) {
    const int lane = threadIdx.x & 63, wave = threadIdx.x >> 6; const size_t m = (size_t)blockIdx.x * 8 + wave;
    const f32x4 h0 = *(const f32x4*)(hL + m * 512 + lane * 8), h1 = *(const f32x4*)(hL + m * 512 + lane * 8 + 4);
    float ss = (h0[0] * h0[0] + h0[1] * h0[1]) + (h0[2] * h0[2] + h0[3] * h0[3]) + (h1[0] * h1[0] + h1[1] * h1[1]) + (h1[2] * h1[2] + h1[3] * h1[3]);
    const float rs = 1.0f / sqrtf(wave_sum(ss) * (1.0f / 512.0f) + LN_EPS);
    const bf16x8 z = *(const bf16x8*)(ZR + m * 512 + lane * 8);
    float y[8];
#pragma unroll
    for (int e = 0; e < 8; ++e) { const float hv = e < 4 ? h0[e] : h1[e - 4]; y[e] = hv * rs * g_r[lane * 8 + e] * silu_f(bf2f((unsigned short)z[e])); }
    v4u w; w.x = pk2(y[0], y[1]); w.y = pk2(y[2], y[3]); w.z = pk2(y[4], y[5]); w.w = pk2(y[6], y[7]);
    *(v4u*)(Y + m * 1024 + 512 + lane * 8) = w;
}
__global__ void __launch_bounds__(512) k_resln(const float* x, const float* yo, const float* modl, const float* gain, const float* bias, float* xout, bf16* XN, const float* modn) {
    const int lane = threadIdx.x & 63, wave = threadIdx.x >> 6; const size_t m = (size_t)blockIdx.x * 8 + wave; const int b = (int)(m / SEQ);
    f32x4 v[4]; float s = 0.f;
#pragma unroll
    for (int j = 0; j < 4; ++j) { const int col = 4 * lane + 256 * j; const f32x4 xv = *(const f32x4*)(x + m * DM + col), yv = *(const f32x4*)(yo + m * DM + col), gt = *(const f32x4*)(modl + (size_t)b * 3072 + 2048 + col);
        v[j] = xv * ALPHA + gt * yv; s += (v[j][0] + v[j][1]) + (v[j][2] + v[j][3]); }
    const float mean = wave_sum(s) * (1.f / DM); float s2 = 0.f;
#pragma unroll
    for (int j = 0; j < 4; ++j) { v[j] = v[j] - mean; s2 += (v[j][0] * v[j][0] + v[j][1] * v[j][1]) + (v[j][2] * v[j][2] + v[j][3] * v[j][3]); }
    const float rstd = 1.f / sqrtf(wave_sum(s2) * (1.f / DM) + LN_EPS);
    float s3 = 0.f;
#pragma unroll
    for (int j = 0; j < 4; ++j) { const int col = 4 * lane + 256 * j; const f32x4 gn = *(const f32x4*)(gain + col), bs = *(const f32x4*)(bias + col);
        v[j] = v[j] * rstd * gn + bs; *(f32x4*)(xout + m * DM + col) = v[j]; s3 += (v[j][0] + v[j][1]) + (v[j][2] + v[j][3]); }
    if (XN) {
        const float mean2 = wave_sum(s3) * (1.f / DM); float s4 = 0.f;
#pragma unroll
        for (int j = 0; j < 4; ++j) { v[j] = v[j] - mean2; s4 += (v[j][0] * v[j][0] + v[j][1] * v[j][1]) + (v[j][2] * v[j][2] + v[j][3] * v[j][3]); }
        const float rstd2 = 1.f / sqrtf(wave_sum(s4) * (1.f / DM) + LN_EPS);
#pragma unroll
        for (int j = 0; j < 4; ++j) { const int col = 4 * lane + 256 * j; const f32x4 sh = *(const f32x4*)(modn + (size_t)b * 3072 + col), sc = *(const f32x4*)(modn + (size_t)b * 3072 + 1024 + col);
            const f32x4 y = v[j] * rstd2 * (sc + 1.0f) + sh;
            *((unsigned long long*)(XN + m * DM + col)) = (unsigned long long)pk2(y[0], y[1]) | ((unsigned long long)pk2(y[2], y[3]) << 32); }
    }
}

extern "C" void kernel_launch(void* const* d_in, const int* in_sizes, int n_in, void* d_out, int out_size, void* d_ws, size_t ws_size, hipStream_t stream) {
    static int grid = 0;
    if (grid == 0) {
        if (n_in != 18 || in_sizes[0] != MTOK * DM || out_size != MTOK * DM || ws_size < WS_END) { fprintf(stderr, "kernel_launch: unexpected shapes (n_in %d, in0 %d, out %d, ws %zu)\n", n_in, n_in > 0 ? in_sizes[0] : -1, out_size, ws_size); grid = -1; return; }
        int dev = 0, cus = 0;
        if (hipGetDevice(&dev) != hipSuccess || hipDeviceGetAttribute(&cus, hipDeviceAttributeMultiprocessorCount, dev) != hipSuccess) { grid = -1; return; }
        if (hipFuncSetAttribute((const void*)mk, hipFuncAttributeMaxDynamicSharedMemorySize, LDS_BYTES) != hipSuccess) { fprintf(stderr, "kernel_launch: hipFuncSetAttribute failed\n"); grid = -1; return; }
        (void)hipGetLastError();
        grid = cus;
    }
    if (grid < 0) return;
    unsigned char* ws = (unsigned char*)d_ws;
    (void)hipMemsetAsync(ws + WS_CTL, 0, CTL_ZERO_BYTES, stream);
    Args a{};
    for (int i = 0; i < 18; ++i) a.in[i] = (const float*)d_in[i];
    a.out = (float*)d_out; a.ws = ws;
    auto run = [&](int lo, int hi, int layer) { a.ph_lo = lo; a.ph_hi = hi; a.layer = layer; hipLaunchKernelGGL(mk, dim3(grid), dim3(NWAVES * 64), LDS_BYTES, stream, a); };
    run(0, 1, 0);
    run(1, 2, 0);
    const float* mod = (const float*)(ws + WS_MOD);
    bf16* PROJ = (bf16*)(ws + WS_PROJ);
    for (int l = 0; l < DEPTH; ++l) {
        run(2, 3, l);
        hipLaunchKernelGGL(k_cumsum, dim3(NBATCH * NH), dim3(512), 0, stream, (const float*)(ws + WS_LOGF), (float*)(ws + WS_DCUM));
        hipLaunchKernelGGL(k_attn_naive, dim3(NBATCH * NH * 32), dim3(256), 0, stream, PROJ + 2 * PROJ_STRIDE, PROJ + 3 * PROJ_STRIDE, PROJ + 4 * PROJ_STRIDE, PROJ + 5 * PROJ_STRIDE,
                           (const float*)(ws + WS_DCUM), a.in[I_NATT] + l * DA, (bf16*)(ws + WS_Y), (float*)(ws + WS_SSQ));
        hipLaunchKernelGGL(k_lru_naive, dim3(NBATCH * NBLK), dim3(64), 0, stream, PROJ, a.in[I_CONVW] + l * 4 * DL, a.in[I_CONVB] + l * DL, a.in[I_WGA] + (size_t)l * 8 * 64 * 64, a.in[I_BGA] + l * DL,
                           a.in[I_WGX] + (size_t)l * 8 * 64 * 64, a.in[I_BGX] + l * DL, a.in[I_LAM] + l * DL, (float*)(ws + WS_HL));
        hipLaunchKernelGGL(k_ynorm_r, dim3(MTOK / 8), dim3(512), 0, stream, (const float*)(ws + WS_HL), PROJ + 1 * PROJ_STRIDE, a.in[I_NLRU] + l * DL, (bf16*)(ws + WS_Y));
        run(4, 5, l);
        const float* xin = l == 0 ? a.in[I_X] : (const float*)(ws + WS_X1);
        float* xout = l == DEPTH - 1 ? (float*)d_out : (float*)(ws + WS_X1);
        hipLaunchKernelGGL(k_resln, dim3(MTOK / 8), dim3(512), 0, stream, xin, (const float*)(ws + WS_YO), mod + (size_t)l * 4 * 3072, a.in[I_LNG] + l * DM, a.in[I_LNB] + l * DM, xout,
                           l == DEPTH - 1 ? (bf16*)nullptr : (bf16*)(ws + WS_XN), mod + (size_t)(l + 1 < DEPTH ? l + 1 : l) * 4 * 3072);
    }
}
```
